# Optimizing an MI355X kernel written in HIP

```python
import math
import jax, jax.numpy as jnp
from jax import lax
import numpy as np

D_MODEL = 1024
BATCH = 32
SEQ = 2048
DEPTH = 4

N_MIXERS = 2
N_CONV_LAYERS = (DEPTH + 1) // 2
N_LRU_LAYERS = DEPTH // 2
SC_WIDTH = 3
LRU_WIDTH = 1280
LRU_HEADS = 10
LRU_BLOCK = LRU_WIDTH // LRU_HEADS
LRU_CONV_WIDTH = 4
LRU_C = 8.0
FFN_HIDDEN = 2816
FFN_CONV_WIDTH = 3
LN_EPS = 1e-5
DEEPNORM_ALPHA = (2.0 * DEPTH) ** 0.25
DEEPNORM_BETA = (8.0 * DEPTH) ** -0.25

kernel_name = "hybrid_shortconv_rglru_convffn_deepnorm"


def causal_dwconv(x, w, b):
    k_width = w.shape[0]
    s = x.shape[1]
    xp = jnp.pad(x, ((0, 0), (k_width - 1, 0), (0, 0)))
    y = xp[:, 0:s] * w[0] + b
    for k in range(1, k_width):
        y = y + xp[:, k:k + s] * w[k]
    return y


def layer_norm(x, g, b):
    xf = x.astype(jnp.float32)
    mu = jnp.mean(xf, axis=-1, keepdims=True)
    var = jnp.mean(jnp.square(xf - mu), axis=-1, keepdims=True)
    y = (xf - mu) * lax.rsqrt(var + LN_EPS)
    return y.astype(x.dtype) * g + b


def short_conv_mixer(x, w_in, conv_w, conv_b, w_out):
    h = jnp.einsum('bsd,de->bse', x, w_in)
    gate_b, gate_c, v = jnp.split(h, 3, axis=-1)
    u = causal_dwconv(gate_c * v, conv_w, conv_b)
    return jnp.einsum('bsd,de->bse', gate_b * u, w_out)


def _lru_combine(left, right):
    a_l, b_l = left
    a_r, b_r = right
    return a_l * a_r, a_r * b_l + b_r


def rglru_block(x, w_in, b_in, conv_w, conv_b, w_gate, b_gate, lam, w_out):
    bsz, s, _ = x.shape
    h = jnp.einsum('bsd,de->bse', x, w_in) + b_in
    g_branch, r_branch = jnp.split(h, 2, axis=-1)
    xr = causal_dwconv(r_branch, conv_w, conv_b)
    xh = xr.reshape(bsz, s, LRU_HEADS, LRU_BLOCK)
    gates = jnp.einsum('bshi,hio->bsho', xh, w_gate) + b_gate
    r_gate, i_gate = jnp.split(gates.astype(jnp.float32), 2, axis=-1)
    r_gate = jax.nn.sigmoid(r_gate).reshape(bsz, s, LRU_WIDTH)
    i_gate = jax.nn.sigmoid(i_gate).reshape(bsz, s, LRU_WIDTH)
    log_a = -LRU_C * r_gate * jax.nn.softplus(-lam.astype(jnp.float32))
    a = jnp.exp(log_a)
    mult = jnp.sqrt(-jnp.expm1(2.0 * log_a))
    b = mult * (i_gate * xr.astype(jnp.float32))
    _, hs = lax.associative_scan(_lru_combine, (a, b), axis=1)
    y = hs.astype(x.dtype) * jax.nn.gelu(g_branch, approximate=True)
    return jnp.einsum('bsr,rd->bsd', y, w_out)


def conv_ffn(x, w_up, conv_w, conv_b, w_down):
    h = jnp.einsum('bsd,df->bsf', x, w_up)
    h = causal_dwconv(h, conv_w, conv_b)
    g, v = jnp.split(h, 2, axis=-1)
    return jnp.einsum('bsf,fd->bsd', jax.nn.silu(g) * v, w_down)


def setup_inputs(seed: int = 0) -> dict:
    key = jax.random.key(seed)
    ks = jax.random.split(key, 24)
    d, r, f = D_MODEL, LRU_WIDTH, FFN_HIDDEN
    nA, nB, L = N_CONV_LAYERS, N_LRU_LAYERS, DEPTH
    nrm = jax.random.normal
    x = nrm(ks[0], (BATCH, SEQ, d), jnp.float32)
    sc_w_in = nrm(ks[1], (nA, d, 3 * d), jnp.float32) * d ** -0.5
    sc_conv_w = nrm(ks[2], (nA, SC_WIDTH, d), jnp.float32) * SC_WIDTH ** -0.5
    sc_conv_b = nrm(ks[3], (nA, d), jnp.float32) * 0.01
    sc_w_out = nrm(ks[4], (nA, d, d), jnp.float32) * d ** -0.5 * DEEPNORM_BETA
    lru_w_in = nrm(ks[5], (nB, d, 2 * r), jnp.float32) * d ** -0.5
    lru_b_in = nrm(ks[6], (nB, 2 * r), jnp.float32) * 0.01
    lru_conv_w = nrm(ks[7], (nB, LRU_CONV_WIDTH, r), jnp.float32) * LRU_CONV_WIDTH ** -0.5
    lru_conv_b = nrm(ks[8], (nB, r), jnp.float32) * 0.01
    lru_w_gate = nrm(ks[9], (nB, LRU_HEADS, LRU_BLOCK, 2 * LRU_BLOCK), jnp.float32) * LRU_BLOCK ** -0.5
    lru_b_gate = nrm(ks[10], (nB, LRU_HEADS, 2 * LRU_BLOCK), jnp.float32) * 0.01
    u = jax.random.uniform(ks[11], (nB, r), jnp.float32, 0.9, 0.999)
    p = u ** (1.0 / LRU_C)
    lru_lambda = jnp.log(p) - jnp.log1p(-p)
    lru_w_out = nrm(ks[12], (nB, r, d), jnp.float32) * r ** -0.5 * DEEPNORM_BETA
    ffn_w_up = nrm(ks[13], (L, d, 2 * f), jnp.float32) * d ** -0.5
    ffn_conv_w = nrm(ks[14], (L, FFN_CONV_WIDTH, 2 * f), jnp.float32) * FFN_CONV_WIDTH ** -0.5
    ffn_conv_b = nrm(ks[15], (L, 2 * f), jnp.float32) * 0.01
    ffn_w_down = nrm(ks[16], (L, f, d), jnp.float32) * f ** -0.5 * DEEPNORM_BETA
    ln_g = 1.0 + 0.02 * nrm(ks[17], (L, 2, d), jnp.float32)
    ln_b = 0.02 * nrm(ks[18], (L, 2, d), jnp.float32)
    return {"x": x,
            "sc_w_in": sc_w_in, "sc_conv_w": sc_conv_w, "sc_conv_b": sc_conv_b, "sc_w_out": sc_w_out,
            "lru_w_in": lru_w_in, "lru_b_in": lru_b_in, "lru_conv_w": lru_conv_w, "lru_conv_b": lru_conv_b,
            "lru_w_gate": lru_w_gate, "lru_b_gate": lru_b_gate, "lru_lambda": lru_lambda, "lru_w_out": lru_w_out,
            "ffn_w_up": ffn_w_up, "ffn_conv_w": ffn_conv_w, "ffn_conv_b": ffn_conv_b, "ffn_w_down": ffn_w_down,
            "ln_g": ln_g, "ln_b": ln_b}


def reference(x, sc_w_in, sc_conv_w, sc_conv_b, sc_w_out,
              lru_w_in, lru_b_in, lru_conv_w, lru_conv_b, lru_w_gate, lru_b_gate, lru_lambda, lru_w_out,
              ffn_w_up, ffn_conv_w, ffn_conv_b, ffn_w_down, ln_g, ln_b):
    for i in range(DEPTH):
        j = i // N_MIXERS
        if i % N_MIXERS == 0:
            y = short_conv_mixer(x, sc_w_in[j], sc_conv_w[j], sc_conv_b[j], sc_w_out[j])
        else:
            y = rglru_block(x, lru_w_in[j], lru_b_in[j], lru_conv_w[j], lru_conv_b[j],
                            lru_w_gate[j], lru_b_gate[j], lru_lambda[j], lru_w_out[j])
        x = layer_norm(DEEPNORM_ALPHA * x + y, ln_g[i, 0], ln_b[i, 0])
        y = conv_ffn(x, ffn_w_up[i], ffn_conv_w[i], ffn_conv_b[i], ffn_w_down[i])
        x = layer_norm(DEEPNORM_ALPHA * x + y, ln_g[i, 1], ln_b[i, 1])
    return x
```

```cpp
#include <hip/hip_runtime.h>
#include <hip/hip_cooperative_groups.h>
#include <cstdio>
namespace cg = cooperative_groups;

#define LAS __attribute__((address_space(3)))
typedef unsigned short bf16_t;
typedef short bf16x8 __attribute__((ext_vector_type(8)));
typedef float f32x4 __attribute__((ext_vector_type(4)));
typedef float f32x2 __attribute__((ext_vector_type(2)));
typedef unsigned u32x4 __attribute__((ext_vector_type(4)));
typedef unsigned u32x2 __attribute__((ext_vector_type(2)));

constexpr int MTOK = 65536, DM = 1024, SEQ = 2048, RW = 1280, FH = 2816, DEPTH = 4;
constexpr int MHALF = 32768;
constexpr float LN_EPS = 1e-5f;
constexpr float ALPHA = 1.681792830507429f;
constexpr int NTHR = 512;
constexpr int LDS_BYTES = 136 * 1024;

constexpr size_t WS_CTL = 0;
constexpr size_t WS_SCIN = 1u << 20;
constexpr size_t WS_SCOUT = WS_SCIN + (size_t)2 * 3072 * 1024 * 2;
constexpr size_t WS_LRUIN = WS_SCOUT + (size_t)2 * 1024 * 1024 * 2;
constexpr size_t WS_LRUG = WS_LRUIN + (size_t)2 * 2560 * 1024 * 2;
constexpr size_t WS_LRUOUT = WS_LRUG + (size_t)2 * 10 * 256 * 128 * 2;
constexpr size_t WS_UP = WS_LRUOUT + (size_t)2 * 1024 * 1280 * 2;
constexpr size_t WS_DOWN = WS_UP + (size_t)4 * 5632 * 1024 * 2;
constexpr size_t WS_X16 = WS_DOWN + (size_t)4 * 1024 * 2816 * 2;
constexpr size_t WS_H = WS_X16 + (size_t)MTOK * DM * 2;
constexpr size_t WS_A = WS_H + (size_t)MTOK * 3072 * 2;
constexpr size_t WS_END = WS_A + (size_t)MHALF * FH * 2;

__device__ __forceinline__ unsigned cvt_pk_bf16(float lo, float hi) { unsigned r; asm volatile("v_cvt_pk_bf16_f32 %0, %1, %2" : "=v"(r) : "v"(lo), "v"(hi)); return r; }
__device__ __forceinline__ float bf_lo(unsigned w) { return __uint_as_float(w << 16); }
__device__ __forceinline__ float bf_hi(unsigned w) { return __uint_as_float(w & 0xffff0000u); }
__device__ __forceinline__ void unpack8(const uint4 v, float (&f)[8]) {
    f[0] = bf_lo(v.x); f[1] = bf_hi(v.x); f[2] = bf_lo(v.y); f[3] = bf_hi(v.y); f[4] = bf_lo(v.z); f[5] = bf_hi(v.z); f[6] = bf_lo(v.w); f[7] = bf_hi(v.w);
}
__device__ __forceinline__ uint4 pack8(const float (&f)[8]) {
    uint4 v; v.x = cvt_pk_bf16(f[0], f[1]); v.y = cvt_pk_bf16(f[2], f[3]); v.z = cvt_pk_bf16(f[4], f[5]); v.w = cvt_pk_bf16(f[6], f[7]); return v;
}
__device__ __forceinline__ void load8f(const float* p, float (&f)[8]) {
    const float4 a = *(const float4*)p, b = *(const float4*)(p + 4);
    f[0] = a.x; f[1] = a.y; f[2] = a.z; f[3] = a.w; f[4] = b.x; f[5] = b.y; f[6] = b.z; f[7] = b.w;
}
__device__ __forceinline__ int tid_fresh() { int t = threadIdx.x; asm volatile("" : "+v"(t)); return t; }
__device__ __forceinline__ float sigmoidf_(float x) { return 1.0f / (1.0f + __expf(-x)); }
__device__ __forceinline__ float gelu_tanh(float x) {
    const float u = 0.7978845608028654f * (x + 0.044715f * x * x * x);
    const float e = __expf(2.0f * u);
    const float th = 1.0f - 2.0f / (e + 1.0f);
    return 0.5f * x * (1.0f + th);
}

namespace pg8 {
constexpr int BM = 256, BK = 64, HALF = 128, HTB = HALF * BK * 2, STAGE_BYTES = 8 * HTB, NXCD = 8, WGM = 8;
__host__ __device__ __forceinline__ int lds_byte(int r, int c) { const int st = (r >> 4) * 2 + (c >> 5), rr = r & 15, cc = c & 31, ob = rr * 64 + cc * 2; return st * 1024 + (ob ^ (((ob >> 9) & 1) << 5)); }
__host__ __device__ __forceinline__ void stage_rc(int b, int& R, int& C) { const int st = b / 1024, sb = b % 1024, swz = sb ^ (((sb >> 9) & 1) << 5); R = (st >> 1) * 16 + swz / 64; C = (st & 1) * 32 + (swz % 64) / 2; }
__host__ __device__ __forceinline__ int perm32(int rho) { const int n = rho >> 4, i = rho & 15; return 8 * (i >> 2) + 4 * n + (i & 3); }

struct Unit { int pm, pn; };
struct Gemm { const bf16_t* A; const bf16_t* Bt; int M, N, K; };

struct StaticOrder {
    int nM, nN, nwg, G, c;
    __device__ void init(int M, int N, int G_, int c_) { nM = M / BM; nN = N / BM; nwg = nM * nN; G = G_; c = c_; }
    __device__ bool next(int i, Unit& u) const {
        const long L = (long)i * G + c; if (L >= nwg) return false;
        int wgid = (int)L; { const int q = nwg / NXCD, r = nwg % NXCD, xcd = wgid % NXCD, off = wgid / NXCD; wgid = (xcd < r ? xcd * (q + 1) : r * (q + 1) + (xcd - r) * q) + off; }
        const int nig = WGM * nN, gid = wgid / nig, fm = gid * WGM, gsz = (nM - fm) < WGM ? (nM - fm) : WGM;
        u.pm = fm + ((wgid % nig) % gsz); u.pn = (wgid % nig) / gsz; return true;
    }
    __device__ __forceinline__ void a_ready(const Unit&) const {}
    __device__ __forceinline__ void done(const Unit&) const {}
};

struct EpiBf16 {
    static constexpr bool PERM = true;
    bf16_t* O; int ldc; const float* bias;
    __device__ __forceinline__ void operator()(const f32x4 (&acc)[2][2][4][2], const Unit& u, int wr, int wc, int fr, int fq) const {
        const int row0 = u.pm * BM + wr * 64 + fr; const int col0 = u.pn * BM + wc * 32 + 8 * fq;
        f32x4 bv[2][2];
#pragma unroll
        for (int bj = 0; bj < 2; ++bj)
#pragma unroll
            for (int n = 0; n < 2; ++n) bv[bj][n] = bias ? *(const f32x4*)(bias + col0 + bj * HALF + 4 * n) : (f32x4){0.f, 0.f, 0.f, 0.f};
#pragma unroll
        for (int ai = 0; ai < 2; ++ai)
#pragma unroll
            for (int m = 0; m < 4; ++m) { bf16_t* rowp = O + (size_t)(row0 + ai * HALF + m * 16) * ldc + col0;
#pragma unroll
                for (int bj = 0; bj < 2; ++bj) { const f32x4 v0 = acc[ai][bj][m][0] + bv[bj][0], v1 = acc[ai][bj][m][1] + bv[bj][1];
                    u32x4 w; w.x = cvt_pk_bf16(v0[0], v0[1]); w.y = cvt_pk_bf16(v0[2], v0[3]); w.z = cvt_pk_bf16(v1[0], v1[1]); w.w = cvt_pk_bf16(v1[2], v1[3]);
                    *(u32x4*)(rowp + bj * HALF) = w; } }
    }
};
struct EpiRes {
    static constexpr bool PERM = false;
    const float* res; float* out; int ldc; float alpha;
    __device__ __forceinline__ void operator()(const f32x4 (&acc)[2][2][4][2], const Unit& u, int wr, int wc, int fr, int fq) const {
        const int row0 = u.pm * BM + wr * 64 + fr, col0 = u.pn * BM + wc * 32 + 4 * fq;
#pragma unroll
        for (int ai = 0; ai < 2; ++ai)
#pragma unroll
            for (int m = 0; m < 4; ++m) { const size_t off = (size_t)(row0 + ai * HALF + m * 16) * ldc + col0;
                f32x4 rv[2][2];
#pragma unroll
                for (int bj = 0; bj < 2; ++bj)
#pragma unroll
                    for (int n = 0; n < 2; ++n) rv[bj][n] = *(const f32x4*)(res + off + bj * HALF + n * 16);
#pragma unroll
                for (int bj = 0; bj < 2; ++bj)
#pragma unroll
                    for (int n = 0; n < 2; ++n) *(f32x4*)(out + off + bj * HALF + n * 16) = rv[bj][n] * alpha + acc[ai][bj][m][n];
                asm volatile("" ::: "memory"); }
    }
};

template <class Epi, class Sched>
__device__ __forceinline__ void gemm_phase(LAS unsigned char* lds, const Gemm g, const Sched& S, const Epi& E) {
    const int tid = tid_fresh(), wid = __builtin_amdgcn_readfirstlane(tid >> 6), lane = tid & 63, wr = wid >> 2, wc = wid & 3, fr = lane & 15, fq = lane >> 4;
    const int K = g.K, nt = K / BK;
    unsigned voffA[2], voffB[2];
#pragma unroll
    for (int i = 0; i < 2; ++i) { int R, C; stage_rc(tid * 16 + i * 8192, R, C); const int Rb = Epi::PERM ? ((R & ~31) + perm32(R & 31)) : R;
        voffA[i] = (unsigned)(R * K + C) * 2u; voffB[i] = (unsigned)(Rb * K + C) * 2u; }
    const size_t kstep = (size_t)(BK * 2);
    const size_t hstep = (size_t)HALF * K * 2;
    const size_t tstep = 2 * hstep;
    const unsigned ldsw = (unsigned)wid * 1024u;
    const int aoff = lds_byte(wr * 64 + fr, fq * 8), boff = lds_byte(wc * 32 + fr, fq * 8);
#define PG8_SA(b, h) (((b) * 2 + (h)) * HTB)
#define PG8_SB(b, h) ((4 + (b) * 2 + (h)) * HTB)
#define PG8_STAGE(bufoff, gbase, voff) do { _Pragma("unroll") for (int _i = 0; _i < 2; ++_i) \
        __builtin_amdgcn_global_load_lds((const unsigned*)((const char*)(gbase) + (voff)[_i]), (LAS unsigned*)(lds + (bufoff) + ldsw + _i * 8192), 16, 0, 0); } while (0)
#define PG8_LDA(dst, b, h) do { _Pragma("unroll") for (int m = 0; m < 4; ++m) _Pragma("unroll") for (int k = 0; k < 2; ++k) dst[m][k] = *(const LAS bf16x8*)(lds + PG8_SA(b, h) + aoff + m * 2048 + k * 1024); } while (0)
#define PG8_LDB(dst, b, h) do { _Pragma("unroll") for (int n = 0; n < 2; ++n) _Pragma("unroll") for (int k = 0; k < 2; ++k) dst[n][k] = *(const LAS bf16x8*)(lds + PG8_SB(b, h) + boff + n * 2048 + k * 1024); } while (0)
#define PG8_MMA(ai, bj, At, Bt) do { __builtin_amdgcn_s_setprio(1); _Pragma("unroll") for (int m = 0; m < 4; ++m) _Pragma("unroll") for (int n = 0; n < 2; ++n) _Pragma("unroll") for (int k = 0; k < 2; ++k) \
        acc[ai][bj][m][n] = __builtin_amdgcn_mfma_f32_16x16x32_bf16(Bt[n][k], At[m][k], acc[ai][bj][m][n], 0, 0, 0); __builtin_amdgcn_s_setprio(0); } while (0)
#define PG8_WAIT_V(n) asm volatile("s_waitcnt vmcnt(" #n ")" ::: "memory")
#define PG8_WAIT_L(n) asm volatile("s_waitcnt lgkmcnt(" #n ")" ::: "memory")
#define PG8_BAR __builtin_amdgcn_s_barrier()
#define PG8_SCHED __builtin_amdgcn_sched_barrier(0)
    Unit cur, nxt; int ui = 0;
    if (!S.next(0, cur)) return;
    f32x4 acc[2][2][4][2];
#pragma unroll
    for (int a = 0; a < 2; ++a)
#pragma unroll
        for (int b = 0; b < 2; ++b)
#pragma unroll
            for (int m = 0; m < 4; ++m)
#pragma unroll
                for (int n = 0; n < 2; ++n) acc[a][b][m][n] = (f32x4){0.f, 0.f, 0.f, 0.f};
    bf16x8 At[4][2], B0[2][2], B1[2][2];
    const char* cA = (const char*)g.A + (size_t)cur.pm * tstep; const char* cB = (const char*)g.Bt + (size_t)cur.pn * tstep;
    S.a_ready(cur);
    PG8_STAGE(PG8_SB(0, 0), cB, voffB); PG8_STAGE(PG8_SA(0, 0), cA, voffA); PG8_STAGE(PG8_SB(0, 1), cB + hstep, voffB); PG8_STAGE(PG8_SA(0, 1), cA + hstep, voffA);
    if (wr == 1) PG8_BAR;
    PG8_WAIT_V(4); PG8_BAR;
    PG8_STAGE(PG8_SB(1, 0), cB + kstep, voffB); PG8_STAGE(PG8_SA(1, 0), cA + kstep, voffA); PG8_STAGE(PG8_SB(1, 1), cB + hstep + kstep, voffB);
    PG8_WAIT_V(6); PG8_BAR;
    for (;;) {
        const bool has_next = S.next(ui + 1, nxt);
        const char* nA = has_next ? (const char*)g.A + (size_t)nxt.pm * tstep : cA; const char* nB = has_next ? (const char*)g.Bt + (size_t)nxt.pn * tstep : cB;
        for (int t = 0; t < nt; t += 2) {
            const bool last = (t == nt - 2);
            const char* a1 = cA + (size_t)(t + 1) * kstep;
            const char* a2 = last ? nA : cA + (size_t)(t + 2) * kstep; const char* b2 = last ? nB : cB + (size_t)(t + 2) * kstep;
            const char* a3 = a2 + kstep; const char* b3 = b2 + kstep;
            if (last && has_next) S.a_ready(nxt);
            PG8_LDB(B0, 0, 0); PG8_SCHED; PG8_LDA(At, 0, 0); PG8_STAGE(PG8_SA(1, 1), a1 + hstep, voffA);
            PG8_WAIT_L(8); PG8_BAR; PG8_WAIT_L(0); PG8_MMA(0, 0, At, B0); PG8_BAR; PG8_SCHED;
            PG8_LDB(B1, 0, 1); PG8_STAGE(PG8_SB(0, 0), b2, voffB);
            PG8_BAR; PG8_WAIT_L(0); PG8_MMA(0, 1, At, B1); PG8_BAR;
            PG8_LDA(At, 0, 1); PG8_STAGE(PG8_SA(0, 0), a2, voffA);
            PG8_BAR; PG8_WAIT_L(0); PG8_MMA(1, 0, At, B0); PG8_BAR; PG8_SCHED;
            PG8_STAGE(PG8_SB(0, 1), b2 + hstep, voffB);
            PG8_WAIT_V(6); PG8_BAR; PG8_MMA(1, 1, At, B1); PG8_BAR;
            PG8_LDB(B0, 1, 0); PG8_SCHED; PG8_LDA(At, 1, 0); PG8_STAGE(PG8_SA(0, 1), a2 + hstep, voffA);
            PG8_WAIT_L(8); PG8_BAR; PG8_WAIT_L(0); PG8_MMA(0, 0, At, B0); PG8_BAR; PG8_SCHED;
            PG8_LDB(B1, 1, 1); PG8_STAGE(PG8_SB(1, 0), b3, voffB);
            PG8_BAR; PG8_WAIT_L(0); PG8_MMA(0, 1, At, B1); PG8_BAR;
            PG8_LDA(At, 1, 1); PG8_STAGE(PG8_SA(1, 0), a3, voffA);
            PG8_BAR; PG8_WAIT_L(0); PG8_MMA(1, 0, At, B0); PG8_BAR; PG8_SCHED;
            PG8_STAGE(PG8_SB(1, 1), b3 + hstep, voffB);
            PG8_WAIT_V(6); PG8_BAR; PG8_MMA(1, 1, At, B1); PG8_BAR;
        }
        E(acc, cur, wr, wc, fr, fq); S.done(cur);
        if (!has_next) break;
#pragma unroll
        for (int a = 0; a < 2; ++a)
#pragma unroll
            for (int b = 0; b < 2; ++b)
#pragma unroll
                for (int m = 0; m < 4; ++m)
#pragma unroll
                    for (int n = 0; n < 2; ++n) acc[a][b][m][n] = (f32x4){0.f, 0.f, 0.f, 0.f};
        cur = nxt; cA = nA; cB = nB; ++ui;
    }
    PG8_WAIT_V(0);
    if (wr == 0) PG8_BAR;
    PG8_BAR;
#undef PG8_SA
#undef PG8_SB
#undef PG8_STAGE
#undef PG8_LDA
#undef PG8_LDB
#undef PG8_MMA
#undef PG8_WAIT_V
#undef PG8_WAIT_L
#undef PG8_BAR
#undef PG8_SCHED
}
}

__device__ __forceinline__ void tconv(unsigned char* smem, const float* src, bf16_t* dst, int K, int N, int nb) {
    float* tile = (float*)smem;
    const int tid = tid_fresh();
    const int tk = K / 64, tn = N / 64, per = tk * tn, total = per * nb;
    for (int t = blockIdx.x; t < total; t += gridDim.x) {
        const int b = t / per, r = t % per, k0 = (r / tn) * 64, n0 = (r % tn) * 64;
        const float* s = src + (size_t)b * K * N; bf16_t* d = dst + (size_t)b * K * N;
        __syncthreads();
#pragma unroll
        for (int i = 0; i < 8; ++i) { const int k = (tid >> 6) + 8 * i, n = tid & 63; tile[k * 65 + n] = s[(size_t)(k0 + k) * N + n0 + n]; }
        __syncthreads();
        { const int n = tid >> 3, kk = (tid & 7) * 8; float f[8];
#pragma unroll
          for (int e = 0; e < 8; ++e) f[e] = tile[(kk + e) * 65 + n];
          *(uint4*)(d + (size_t)(n0 + n) * K + k0 + kk) = pack8(f); }
    }
    __syncthreads();
}
__device__ __forceinline__ void xconv(const float* x, bf16_t* x16) {
    const size_t n8 = (size_t)MTOK * DM / 8;
    const int tid = tid_fresh();
    for (size_t i = (size_t)blockIdx.x * NTHR + tid; i < n8; i += (size_t)gridDim.x * NTHR) {
        float f[8]; load8f(x + i * 8, f); *(uint4*)(x16 + i * 8) = pack8(f);
    }
}

__device__ __forceinline__ void ln_phase(float* z, bf16_t* x16, const float* g, const float* b) {
    const int tid = tid_fresh(); const int lane = tid & 63, wv = tid >> 6;
    f32x4 gv[4], bv[4];
#pragma unroll
    for (int i = 0; i < 4; ++i) { gv[i] = *(const f32x4*)(g + lane * 4 + 256 * i); bv[i] = *(const f32x4*)(b + lane * 4 + 256 * i); }
    for (int row = blockIdx.x * 8 + wv; row < MTOK; row += gridDim.x * 8) {
        float* zp = z + (size_t)row * DM + lane * 4;
        f32x4 v[4];
#pragma unroll
        for (int i = 0; i < 4; ++i) v[i] = *(const f32x4*)(zp + 256 * i);
        float s = 0.f;
#pragma unroll
        for (int i = 0; i < 4; ++i) s += (v[i][0] + v[i][1]) + (v[i][2] + v[i][3]);
#pragma unroll
        for (int o = 32; o >= 1; o >>= 1) s += __shfl_xor(s, o);
        const float mean = s * (1.0f / 1024.0f);
        float q = 0.f;
#pragma unroll
        for (int i = 0; i < 4; ++i) { const f32x4 d = v[i] - mean; q += (d[0] * d[0] + d[1] * d[1]) + (d[2] * d[2] + d[3] * d[3]); }
#pragma unroll
        for (int o = 32; o >= 1; o >>= 1) q += __shfl_xor(q, o);
        const float rstd = 1.0f / sqrtf(q * (1.0f / 1024.0f) + LN_EPS);
        bf16_t* xp = x16 + (size_t)row * DM + lane * 4;
#pragma unroll
        for (int i = 0; i < 4; ++i) { const f32x4 o = (v[i] - mean) * rstd * gv[i] + bv[i];
            *(f32x4*)(zp + 256 * i) = o;
            u32x2 w; w.x = cvt_pk_bf16(o[0], o[1]); w.y = cvt_pk_bf16(o[2], o[3]); *(u32x2*)(xp + 256 * i) = w; }
    }
}

__device__ __forceinline__ void sc_elem_phase(const bf16_t* h  , bf16_t* a  , const float* cw  , const float* cb) {
    const int nth = gridDim.x * NTHR;
    const int ntasks = (MTOK / 16) * 128;
    const int tid = tid_fresh();
    for (int task = blockIdx.x * NTHR + tid; task < ntasks; task += nth) {
        const int cgp = task & 127, run = task >> 7, t0 = run * 16, d0 = cgp * 8;
        float w0[8], w1[8], w2[8], bb[8];
        load8f(cw + d0, w0); load8f(cw + 1024 + d0, w1); load8f(cw + 2048 + d0, w2); load8f(cb + d0, bb);
        float p2[8], p1[8];
        const bf16_t* hp = h + (size_t)t0 * 3072 + d0;
        if ((t0 & (SEQ - 1)) == 0) {
#pragma unroll
            for (int e = 0; e < 8; ++e) { p2[e] = 0.f; p1[e] = 0.f; }
        } else {
            float c[8], v[8];
            unpack8(*(const uint4*)(hp - 2 * 3072 + 1024), c); unpack8(*(const uint4*)(hp - 2 * 3072 + 2048), v);
#pragma unroll
            for (int e = 0; e < 8; ++e) p2[e] = c[e] * v[e];
            unpack8(*(const uint4*)(hp - 3072 + 1024), c); unpack8(*(const uint4*)(hp - 3072 + 2048), v);
#pragma unroll
            for (int e = 0; e < 8; ++e) p1[e] = c[e] * v[e];
        }
        bf16_t* ap = a + (size_t)t0 * 1024 + d0;
#pragma unroll 4
        for (int i = 0; i < 16; ++i) {
            float gb[8], c[8], v[8], o[8];
            unpack8(*(const uint4*)(hp + (size_t)i * 3072), gb); unpack8(*(const uint4*)(hp + (size_t)i * 3072 + 1024), c); unpack8(*(const uint4*)(hp + (size_t)i * 3072 + 2048), v);
#pragma unroll
            for (int e = 0; e < 8; ++e) { const float cv = c[e] * v[e]; const float u = bb[e] + w0[e] * p2[e] + w1[e] * p1[e] + w2[e] * cv; o[e] = gb[e] * u; p2[e] = p1[e]; p1[e] = cv; }
            *(uint4*)(ap + (size_t)i * 1024) = pack8(o);
        }
    }
}

__device__ __forceinline__ void ffn_elem_phase(const bf16_t* h  , bf16_t* a  , const float* cw  , const float* cb  ) {
    const int nth = gridDim.x * NTHR;
    constexpr int NG = FH / 8;
    const int ntasks = (MHALF / 16) * NG;
    const int tid = tid_fresh();
    for (int task = blockIdx.x * NTHR + tid; task < ntasks; task += nth) {
        const int cgp = task % NG, run = task / NG, t0 = run * 16, f0 = cgp * 8;
        float g0[8], g1[8], g2[8], gbv[8], v0[8], v1[8], v2[8], vbv[8];
        load8f(cw + f0, g0); load8f(cw + 5632 + f0, g1); load8f(cw + 2 * 5632 + f0, g2); load8f(cb + f0, gbv);
        load8f(cw + FH + f0, v0); load8f(cw + 5632 + FH + f0, v1); load8f(cw + 2 * 5632 + FH + f0, v2); load8f(cb + FH + f0, vbv);
        float pg2[8], pg1[8], pv2[8], pv1[8];
        const bf16_t* hp = h + (size_t)t0 * 5632 + f0;
        if ((t0 & (SEQ - 1)) == 0) {
#pragma unroll
            for (int e = 0; e < 8; ++e) { pg2[e] = 0.f; pg1[e] = 0.f; pv2[e] = 0.f; pv1[e] = 0.f; }
        } else {
            unpack8(*(const uint4*)(hp - 2 * 5632), pg2); unpack8(*(const uint4*)(hp - 2 * 5632 + FH), pv2);
            unpack8(*(const uint4*)(hp - 5632), pg1); unpack8(*(const uint4*)(hp - 5632 + FH), pv1);
        }
        bf16_t* ap = a + (size_t)t0 * FH + f0;
#pragma unroll 4
        for (int i = 0; i < 16; ++i) {
            float cg[8], cv[8], o[8];
            unpack8(*(const uint4*)(hp + (size_t)i * 5632), cg); unpack8(*(const uint4*)(hp + (size_t)i * 5632 + FH), cv);
#pragma unroll
            for (int e = 0; e < 8; ++e) {
                const float yg = gbv[e] + g0[e] * pg2[e] + g1[e] * pg1[e] + g2[e] * cg[e];
                const float yv = vbv[e] + v0[e] * pv2[e] + v1[e] * pv1[e] + v2[e] * cv[e];
                o[e] = yg * sigmoidf_(yg) * yv;
                pg2[e] = pg1[e]; pg1[e] = cg[e]; pv2[e] = pv1[e]; pv1[e] = cv[e];
            }
            *(uint4*)(ap + (size_t)i * FH) = pack8(o);
        }
    }
}

__device__ __forceinline__ void lru_mid_phase(unsigned char* smem, const bf16_t* h  , bf16_t* y  ,
                                              const float* cw  , const float* cb  , const bf16_t* wgt  ,
                                              const float* bg  , const float* lam  ) {
    constexpr int T = 128, RS = 272;
    unsigned char* WqL = smem;
    unsigned char* xrA = smem + 17408;
    float* xr32 = (float*)(smem + 52224);
    float* aL = (float*)(smem + 68608);
    float* bL = (float*)(smem + 85504);
    float* segL = (float*)(smem + 102400);
    float* carryL = (float*)(smem + 106496);
    float* tabL = (float*)(smem + 106496 + 128);
    const int tid = tid_fresh(), lane = tid & 63, w = tid >> 6, fr = lane & 15, fq = lane >> 4;
    const int cgp = tid & 15, rg = tid >> 4;
    const int sch = tid & 31, seg = tid >> 5;
    for (int it = blockIdx.x; it < 1280; it += gridDim.x) {
        const int q = it & 3, hd = (it >> 2) % 10, b = it / 40;
        const int c0 = hd * 128 + q * 32;
        __syncthreads();
        for (int i = tid; i < 1024; i += NTHR) { const int j = i >> 4, kc = i & 15; const int o = (j < 32) ? (q * 32 + j) : (128 + q * 32 + (j - 32));
            *(uint4*)(WqL + j * RS + kc * 16) = *(const uint4*)(wgt + ((size_t)(hd * 256 + o)) * 128 + kc * 8); }
        if (tid < 32) { tabL[tid] = bg[hd * 256 + q * 32 + tid]; tabL[32 + tid] = bg[hd * 256 + 128 + q * 32 + tid];
            tabL[64 + tid] = log1pf(expf(-lam[c0 + tid])); carryL[tid] = 0.f; }
        __syncthreads();
        float br_[8], bi_[8], sp_[8];
#pragma unroll
        for (int j = 0; j < 2; ++j)
#pragma unroll
            for (int e = 0; e < 4; ++e) { const int ch = 16 * j + 4 * fq + e; br_[j * 4 + e] = tabL[ch]; bi_[j * 4 + e] = tabL[32 + ch]; sp_[j * 4 + e] = tabL[64 + ch]; }
        float cw0[8], cw1[8], cw2[8], cw3[8], cbv[8];
        { const int cc = hd * 128 + cgp * 8; load8f(cw + cc, cw0); load8f(cw + RW + cc, cw1); load8f(cw + 2 * RW + cc, cw2); load8f(cw + 3 * RW + cc, cw3); load8f(cb + cc, cbv); }
        for (int chunk = 0; chunk < SEQ / T; ++chunk) {
            const int t0 = chunk * T;
            const size_t rowbase = (size_t)b * SEQ + t0;
            {
                const int r0 = rg * 4;
                const bf16_t* src = h + (rowbase + r0) * 2560 + RW + hd * 128 + cgp * 8;
                float rv[7][8];
#pragma unroll
                for (int k = 0; k < 7; ++k) {
                    const int tt = t0 + r0 - 3 + k;
                    uint4 raw = make_uint4(0u, 0u, 0u, 0u);
                    if (tt >= 0) raw = *(const uint4*)(src + (ptrdiff_t)(k - 3) * 2560);
                    unpack8(raw, rv[k]);
                }
#pragma unroll
                for (int i = 0; i < 4; ++i) {
                    float o[8];
#pragma unroll
                    for (int e = 0; e < 8; ++e) o[e] = cbv[e] + cw0[e] * rv[i][e] + cw1[e] * rv[i + 1][e] + cw2[e] * rv[i + 2][e] + cw3[e] * rv[i + 3][e];
                    *(uint4*)(xrA + (r0 + i) * RS + cgp * 16) = pack8(o);
                    if ((cgp >> 2) == q) { float* xp = xr32 + (r0 + i) * 32 + (cgp & 3) * 8;
                        *(float4*)xp = make_float4(o[0], o[1], o[2], o[3]); *(float4*)(xp + 4) = make_float4(o[4], o[5], o[6], o[7]); }
                }
            }
            unsigned short gvr[8];
#pragma unroll
            for (int r = 0; r < 8; ++r) gvr[r] = h[(rowbase + seg * 8 + r) * 2560 + c0 + sch];
            __syncthreads();
            f32x4 acc[4];
#pragma unroll
            for (int j = 0; j < 4; ++j) acc[j] = (f32x4){0.f, 0.f, 0.f, 0.f};
#pragma unroll
            for (int ks = 0; ks < 4; ++ks) {
                const bf16x8 af = *(const bf16x8*)(xrA + (16 * w + fr) * RS + ks * 64 + fq * 16);
#pragma unroll
                for (int j = 0; j < 4; ++j) { const bf16x8 bfr = *(const bf16x8*)(WqL + (16 * j + fr) * RS + ks * 64 + fq * 16);
                    acc[j] = __builtin_amdgcn_mfma_f32_16x16x32_bf16(bfr, af, acc[j], 0, 0, 0); }
            }
            {
                const int row = 16 * w + fr;
#pragma unroll
                for (int j = 0; j < 2; ++j)
#pragma unroll
                    for (int e = 0; e < 4; ++e) {
                        const int ch = 16 * j + 4 * fq + e;
                        const float rgt = sigmoidf_(acc[j][e] + br_[j * 4 + e]);
                        const float igt = sigmoidf_(acc[j + 2][e] + bi_[j * 4 + e]);
                        const float la = -8.0f * rgt * sp_[j * 4 + e];
                        const float av = __expf(la);
                        const float mult = sqrtf(-expm1f(2.0f * la));
                        const float xv = xr32[row * 32 + ch];
                        aL[row * 33 + ch] = av; bL[row * 33 + ch] = mult * igt * xv;
                    }
            }
            __syncthreads();
            float Ap = 1.f, Hh = 0.f;
#pragma unroll
            for (int r = 0; r < 8; ++r) { const int idx = (seg * 8 + r) * 33 + sch; const float av = aL[idx], bv = bL[idx]; Hh = av * Hh + bv; Ap *= av; aL[idx] = Ap; bL[idx] = Hh; }
            segL[(seg * 32 + sch) * 2] = Ap; segL[(seg * 32 + sch) * 2 + 1] = Hh;
            __syncthreads();
            float cin = carryL[sch];
            for (int s = 0; s < seg; ++s) cin = segL[(s * 32 + sch) * 2] * cin + segL[(s * 32 + sch) * 2 + 1];
#pragma unroll
            for (int r = 0; r < 8; ++r) { const int idx = (seg * 8 + r) * 33 + sch; const float hv = bL[idx] + aL[idx] * cin;
                const float gvf = __uint_as_float(((unsigned)gvr[r]) << 16);
                const float yv = hv * gelu_tanh(gvf);
                y[(rowbase + seg * 8 + r) * RW + c0 + sch] = (bf16_t)(cvt_pk_bf16(yv, 0.f) & 0xffffu); }
            __syncthreads();
            if (seg == 15) carryL[sch] = Ap * cin + Hh;
        }
    }
    __syncthreads();
}

struct Params { const float* in[19]; float* out; unsigned char* ws; };

__global__ void __launch_bounds__(NTHR, 2) fwd_megakernel(Params p) {
    extern __shared__ __attribute__((aligned(16))) unsigned char smem[];
    cg::grid_group grid = cg::this_grid();
    LAS unsigned char* lds = (LAS unsigned char*)smem;
    unsigned char* ws = p.ws;
    bf16_t* wt_scin = (bf16_t*)(ws + WS_SCIN); bf16_t* wt_scout = (bf16_t*)(ws + WS_SCOUT); bf16_t* wt_lruin = (bf16_t*)(ws + WS_LRUIN);
    bf16_t* wt_lrug = (bf16_t*)(ws + WS_LRUG); bf16_t* wt_lruout = (bf16_t*)(ws + WS_LRUOUT); bf16_t* wt_up = (bf16_t*)(ws + WS_UP); bf16_t* wt_down = (bf16_t*)(ws + WS_DOWN);
    bf16_t* x16 = (bf16_t*)(ws + WS_X16); bf16_t* hbuf = (bf16_t*)(ws + WS_H); bf16_t* abuf = (bf16_t*)(ws + WS_A);
    const int G = gridDim.x, c = blockIdx.x;

    tconv(smem, p.in[1], wt_scin, 1024, 3072, 2);
    tconv(smem, p.in[4], wt_scout, 1024, 1024, 2);
    tconv(smem, p.in[5], wt_lruin, 1024, 2560, 2);
    tconv(smem, p.in[9], wt_lrug, 128, 256, 20);
    tconv(smem, p.in[12], wt_lruout, 1280, 1024, 2);
    tconv(smem, p.in[13], wt_up, 1024, 5632, 4);
    tconv(smem, p.in[16], wt_down, 2816, 1024, 4);
    xconv(p.in[0], x16);
    grid.sync();

    for (int layer = 0; layer < DEPTH; ++layer) {
        const int j = layer >> 1;
        const bool is_conv = (layer & 1) == 0;
        {
            pg8::Gemm g; pg8::EpiBf16 E;
            if (is_conv) { g = pg8::Gemm{x16, wt_scin + (size_t)j * 3072 * 1024, MTOK, 3072, 1024}; E = pg8::EpiBf16{hbuf, 3072, nullptr}; }
            else { g = pg8::Gemm{x16, wt_lruin + (size_t)j * 2560 * 1024, MTOK, 2560, 1024}; E = pg8::EpiBf16{hbuf, 2560, p.in[6] + (size_t)j * 2560}; }
            pg8::StaticOrder S; S.init(g.M, g.N, G, c);
            pg8::gemm_phase<pg8::EpiBf16, pg8::StaticOrder>(lds, g, S, E);
        }
        grid.sync();
        if (is_conv) sc_elem_phase(hbuf, abuf, p.in[2] + (size_t)j * 3 * 1024, p.in[3] + (size_t)j * 1024);
        else lru_mid_phase(smem, hbuf, abuf, p.in[7] + (size_t)j * 4 * RW, p.in[8] + (size_t)j * RW, wt_lrug + (size_t)j * 10 * 256 * 128,
                           p.in[10] + (size_t)j * 10 * 256, p.in[11] + (size_t)j * RW);
        grid.sync();
        {
            pg8::Gemm g;
            if (is_conv) g = pg8::Gemm{abuf, wt_scout + (size_t)j * 1024 * 1024, MTOK, 1024, 1024};
            else g = pg8::Gemm{abuf, wt_lruout + (size_t)j * 1024 * 1280, MTOK, 1024, 1280};
            pg8::EpiRes E{layer == 0 ? p.in[0] : p.out, p.out, DM, ALPHA};
            pg8::StaticOrder S; S.init(g.M, g.N, G, c);
            pg8::gemm_phase<pg8::EpiRes, pg8::StaticOrder>(lds, g, S, E);
        }
        grid.sync();
        ln_phase(p.out, x16, p.in[17] + (size_t)(layer * 2 + 0) * DM, p.in[18] + (size_t)(layer * 2 + 0) * DM);
        grid.sync();
        for (int hf = 0; hf < 2; ++hf) {
            {
                pg8::Gemm g{x16 + (size_t)hf * MHALF * DM, wt_up + (size_t)layer * 5632 * 1024, MHALF, 5632, 1024};
                pg8::EpiBf16 E{hbuf, 5632, nullptr};
                pg8::StaticOrder S; S.init(g.M, g.N, G, c);
                pg8::gemm_phase<pg8::EpiBf16, pg8::StaticOrder>(lds, g, S, E);
            }
            grid.sync();
            ffn_elem_phase(hbuf, abuf, p.in[14] + (size_t)layer * 3 * 5632, p.in[15] + (size_t)layer * 5632);
            grid.sync();
            {
                pg8::Gemm g{abuf, wt_down + (size_t)layer * 1024 * 2816, MHALF, 1024, 2816};
                float* zo = p.out + (size_t)hf * MHALF * DM;
                pg8::EpiRes E{zo, zo, DM, ALPHA};
                pg8::StaticOrder S; S.init(g.M, g.N, G, c);
                pg8::gemm_phase<pg8::EpiRes, pg8::StaticOrder>(lds, g, S, E);
            }
            grid.sync();
        }
        ln_phase(p.out, x16, p.in[17] + (size_t)(layer * 2 + 1) * DM, p.in[18] + (size_t)(layer * 2 + 1) * DM);
        if (layer + 1 < DEPTH) grid.sync();
    }
}

extern "C" void kernel_launch(void* const* d_in, const int* in_sizes, int n_in, void* d_out, int out_size, void* d_ws, size_t ws_size, hipStream_t stream) {
    static int grid_blocks = 0;
    if (grid_blocks == 0) {
        if (n_in != 19 || ws_size < WS_END) { fprintf(stderr, "kernel_launch: unexpected n_in %d or ws_size %zu (< %zu)\n", n_in, ws_size, (size_t)WS_END); grid_blocks = -1; return; }
        int dev = 0, cus = 0, per_cu = 0;
        hipGetDevice(&dev);
        hipDeviceGetAttribute(&cus, hipDeviceAttributeMultiprocessorCount, dev);
        if (hipFuncSetAttribute((const void*)fwd_megakernel, hipFuncAttributeMaxDynamicSharedMemorySize, LDS_BYTES) != hipSuccess) { fprintf(stderr, "kernel_launch: hipFuncSetAttribute failed\n"); grid_blocks = -1; return; }
        hipOccupancyMaxActiveBlocksPerMultiprocessor(&per_cu, (const void*)fwd_megakernel, NTHR, LDS_BYTES);
        if (per_cu < 1) { fprintf(stderr, "kernel_launch: occupancy query says %d blocks per CU\n", per_cu); per_cu = 1; }
        (void)hipGetLastError();
        grid_blocks = cus;
    }
    if (grid_blocks < 0) return;
    Params p{};
    for (int i = 0; i < 19; ++i) p.in[i] = (const float*)d_in[i];
    p.out = (float*)d_out; p.ws = (unsigned char*)d_ws;
    void* args[] = {&p};
    hipError_t e = hipLaunchCooperativeKernel((const void*)fwd_megakernel, dim3(grid_blocks), dim3(NTHR), args, LDS_BYTES, stream);
    if (e != hipSuccess) fprintf(stderr, "cooperative launch failed: %s (grid %d)\n", hipGetErrorString(e), grid_blocks);
}
```
